# Optimizing an MI355X kernel written in HIP

```python
import jax, jax.numpy as jnp
from jax import lax
import numpy as np

D_MODEL = 2048
BATCH = 4
SEQ = 2048
DEPTH = 1
DEC_BATCH = 128
DEC_SEQ = 8
PAST_LEN = 16384
PAGE_SIZE = 128

D_POOL = D_MODEL // 2
POOL_WINDOWS = (2, 4, 8, 16)
N_POOL_GROUPS = len(POOL_WINDOWS)
POOL_GROUP_W = D_POOL // N_POOL_GROUPS
POOL_STATE = max(POOL_WINDOWS) - 1
D_CONV = D_MODEL // 2
CONV_WIDTH = 31
CONV_STATE = CONV_WIDTH - 1
D_PLE = 256
EPS = 1e-6
D_IN = 2 * D_POOL + 3 * D_CONV + 2 * D_MODEL

kernel_name = "gated_pool_conformer_hybrid_step"


def rms_norm(x, g):
    xf = x.astype(jnp.float32)
    y = xf * lax.rsqrt(jnp.mean(xf * xf, axis=-1, keepdims=True) + EPS)
    return (y * g.astype(jnp.float32)).astype(x.dtype)


def layer_norm(x, g, b):
    xf = x.astype(jnp.float32)
    mu = jnp.mean(xf, axis=-1, keepdims=True)
    xc = xf - mu
    y = xc * lax.rsqrt(jnp.mean(xc * xc, axis=-1, keepdims=True) + EPS)
    return (y * g.astype(jnp.float32) + b.astype(jnp.float32)).astype(x.dtype)


def pool_mixer(u, past, start_pos, w_pool, pool_scale):
    B, T, _ = u.shape
    L = POOL_STATE
    ext = jnp.concatenate([past.astype(u.dtype), u], axis=1)
    extf = ext.astype(jnp.float32)
    csum = jnp.concatenate([jnp.zeros((B, 1, D_POOL), jnp.float32), jnp.cumsum(extf, axis=1)], axis=1)
    end = csum[:, L + 1:]
    pos = start_pos + jnp.arange(T)
    outs = []
    for gi, w in enumerate(POOL_WINDOWS):
        sl = slice(gi * POOL_GROUP_W, (gi + 1) * POOL_GROUP_W)
        win_sum = end[..., sl] - csum[:, L + 1 - w:L + 1 - w + T, sl]
        count = jnp.minimum(pos + 1, w).astype(jnp.float32)
        outs.append(win_sum / count[None, :, None])
    pooled = jnp.concatenate(outs, axis=-1) - extf[:, L:]
    pooled = pooled.astype(u.dtype).reshape(B, T, N_POOL_GROUPS, POOL_GROUP_W)
    mixed = jnp.einsum('btgc,gcd->btgd', pooled, w_pool).reshape(B, T, D_POOL)
    return mixed * pool_scale, ext[:, -L:]


def conv_module(a, b, past, w_dw, b_dw, ln_g, ln_b):
    v = a * jax.nn.sigmoid(b)
    ext = jnp.concatenate([past.astype(v.dtype), v], axis=1)
    y = lax.conv_general_dilated(
        ext, w_dw[:, None, :].astype(ext.dtype), window_strides=(1,), padding='VALID',
        dimension_numbers=('NWC', 'WIO', 'NWC'), feature_group_count=D_CONV)
    y = y + b_dw
    y = jax.nn.silu(layer_norm(y, ln_g, ln_b))
    return y, ext[:, -CONV_STATE:]


def hybrid_layer(x, p, pool_past, conv_past, start_pos, g_pre, w_in, w_pool, pool_scale,
                 w_dw, b_dw, ln_g, ln_b, w_proj_pool, w_proj_conv, w_out, g_post,
                 w_ple, g_ple, w_ple_gate):
    h = rms_norm(x, g_pre)
    proj = h @ w_in
    o = 0
    u_a = proj[..., o:o + D_POOL]; o += D_POOL
    z_a = proj[..., o:o + D_POOL]; o += D_POOL
    a_b = proj[..., o:o + D_CONV]; o += D_CONV
    b_b = proj[..., o:o + D_CONV]; o += D_CONV
    z_b = proj[..., o:o + D_CONV]; o += D_CONV
    gate_a = proj[..., o:o + D_MODEL]; o += D_MODEL
    gate_b = proj[..., o:o + D_MODEL]
    ya, pool_new = pool_mixer(u_a, pool_past, start_pos, w_pool, pool_scale)
    ya = (ya * jax.nn.silu(z_a)) @ w_proj_pool
    yb, conv_new = conv_module(a_b, b_b, conv_past, w_dw, b_dw, ln_g, ln_b)
    yb = (yb * jax.nn.silu(z_b)) @ w_proj_conv
    m = jax.nn.sigmoid(gate_a) * ya + jax.nn.sigmoid(gate_b) * yb
    x = x + rms_norm(m @ w_out, g_post)
    e = rms_norm(p.astype(x.dtype) @ w_ple, g_ple)
    x = x + e * jax.nn.sigmoid(x @ w_ple_gate)
    return x, pool_new, conv_new


def setup_inputs(seed: int = 0) -> dict:
    key = jax.random.key(seed)
    ks = jax.random.split(key, 24)
    f32 = jnp.float32
    nrm = lambda k, s, sc: jax.random.normal(k, s, f32) * sc
    return {
        "x_prompt": nrm(ks[0], (BATCH, SEQ, D_MODEL), 1.0),
        "x_sample": nrm(ks[1], (DEC_BATCH, DEC_SEQ, D_MODEL), 1.0),
        "state_pool": nrm(ks[2], (DEPTH, DEC_BATCH, POOL_STATE, D_POOL), 1.0),
        "state_conv": nrm(ks[3], (DEPTH, DEC_BATCH, CONV_STATE, D_CONV), 0.5),
        "p_prompt": nrm(ks[4], (DEPTH, BATCH, SEQ, D_PLE), 1.0),
        "p_sample": nrm(ks[5], (DEPTH, DEC_BATCH, DEC_SEQ, D_PLE), 1.0),
        "g_pre": 1.0 + nrm(ks[6], (DEPTH, D_MODEL), 0.05),
        "w_in": nrm(ks[7], (DEPTH, D_MODEL, D_IN), D_MODEL ** -0.5),
        "w_pool": nrm(ks[8], (DEPTH, N_POOL_GROUPS, POOL_GROUP_W, POOL_GROUP_W), POOL_GROUP_W ** -0.5),
        "pool_scale": 1.0 + nrm(ks[9], (DEPTH, D_POOL), 0.1),
        "w_dw": nrm(ks[10], (DEPTH, CONV_WIDTH, D_CONV), CONV_WIDTH ** -0.5),
        "b_dw": nrm(ks[11], (DEPTH, D_CONV), 0.02),
        "ln_g": 1.0 + nrm(ks[12], (DEPTH, D_CONV), 0.05),
        "ln_b": nrm(ks[13], (DEPTH, D_CONV), 0.02),
        "w_proj_pool": nrm(ks[14], (DEPTH, D_POOL, D_MODEL), D_POOL ** -0.5),
        "w_proj_conv": nrm(ks[15], (DEPTH, D_CONV, D_MODEL), D_CONV ** -0.5),
        "w_out": nrm(ks[16], (DEPTH, D_MODEL, D_MODEL), D_MODEL ** -0.5),
        "g_post": 1.0 + nrm(ks[17], (DEPTH, D_MODEL), 0.05),
        "w_ple": nrm(ks[18], (DEPTH, D_PLE, D_MODEL), D_PLE ** -0.5),
        "g_ple": 1.0 + nrm(ks[19], (DEPTH, D_MODEL), 0.05),
        "w_ple_gate": nrm(ks[20], (DEPTH, D_MODEL, D_MODEL), D_MODEL ** -0.5),
    }


def reference(x_prompt, x_sample, state_pool, state_conv, p_prompt, p_sample, g_pre, w_in,
              w_pool, pool_scale, w_dw, b_dw, ln_g, ln_b, w_proj_pool, w_proj_conv, w_out,
              g_post, w_ple, g_ple, w_ple_gate):
    xp, xs = x_prompt, x_sample
    pool_p, conv_p, pool_s, conv_s = [], [], [], []
    for i in range(DEPTH):
        lw = (g_pre[i], w_in[i], w_pool[i], pool_scale[i], w_dw[i], b_dw[i], ln_g[i], ln_b[i],
              w_proj_pool[i], w_proj_conv[i], w_out[i], g_post[i], w_ple[i], g_ple[i], w_ple_gate[i])
        zp_pool = jnp.zeros((xp.shape[0], POOL_STATE, D_POOL), xp.dtype)
        zp_conv = jnp.zeros((xp.shape[0], CONV_STATE, D_CONV), xp.dtype)
        xp, npp, ncp = hybrid_layer(xp, p_prompt[i], zp_pool, zp_conv, 0, *lw)
        xs, nps, ncs = hybrid_layer(xs, p_sample[i], state_pool[i], state_conv[i], PAST_LEN, *lw)
        pool_p.append(npp); conv_p.append(ncp); pool_s.append(nps); conv_s.append(ncs)
    new_pool_prompt = jnp.stack(pool_p)
    new_conv_prompt = jnp.stack(conv_p)
    new_pool_sample = jnp.stack(pool_s)
    new_conv_sample = jnp.stack(conv_s)
    return (xp, xs, new_pool_prompt, new_conv_prompt, new_pool_sample, new_conv_sample)
```

```cpp
#include <hip/hip_runtime.h>
#include <hip/hip_cooperative_groups.h>
#include <cstdio>
#include <cstdint>
namespace cg = cooperative_groups;

#ifndef MK_MULTI
#define MK_MULTI 1
#endif

#define LAS __attribute__((address_space(3)))
typedef unsigned short bf16_t;
typedef short bf16x8 __attribute__((ext_vector_type(8)));
typedef float f32x4 __attribute__((ext_vector_type(4)));
typedef float f32x2 __attribute__((ext_vector_type(2)));
typedef unsigned u32x4 __attribute__((ext_vector_type(4)));
typedef unsigned u32x2 __attribute__((ext_vector_type(2)));

constexpr int DM = 2048, MP = 8192, MS = 1024, M = MP + MS, SEQ = 2048, DSEQ = 8, DBATCH = 128;
constexpr int DP = 1024, DC = 1024, DPLE = 256, DIN = 9216;
constexpr float EPS = 1e-6f;
constexpr int NPHASE = 7;
constexpr size_t O_Y = 0, O_PP = (size_t)M * DM, O_CP = O_PP + 4 * 15 * 1024, O_PS = O_CP + 4 * 30 * 1024, O_CS = O_PS + (size_t)128 * 15 * 1024;
constexpr size_t MiB = 1u << 20;
constexpr size_t WS_XB = 0;
constexpr size_t WS_WIN = 36 * MiB;
constexpr size_t WS_POOLED = 36 * MiB, WS_YA = 54 * MiB;
constexpr size_t WS_U = 72 * MiB, WS_SZA = 90 * MiB;
constexpr size_t WS_T = 72 * MiB;
constexpr size_t WS_V = 108 * MiB, WS_SZB = 126 * MiB;
constexpr size_t WS_EB = 108 * MiB;
constexpr size_t WS_GA = 144 * MiB, WS_GB = 180 * MiB, WS_YB = 216 * MiB;
constexpr size_t WS_PB = 234 * MiB, WS_WPLE = 239 * MiB, WS_WPOOL = 240 * MiB, WS_WPP = 241 * MiB, WS_WPC = 245 * MiB;
constexpr size_t WS_WOUT = 249 * MiB, WS_WG = 257 * MiB, WS_STAT = 265 * MiB, WS_END = 266 * MiB;
constexpr int LDS_BYTES = 147456;
constexpr int RED_OFF = 131072;

__device__ __forceinline__ unsigned cvt_pk_bf16(float lo, float hi) { unsigned r; asm volatile("v_cvt_pk_bf16_f32 %0, %1, %2" : "=v"(r) : "v"(lo), "v"(hi)); return r; }
__device__ __forceinline__ float bf_lo(unsigned v) { return __builtin_bit_cast(float, v << 16); }
__device__ __forceinline__ float bf_hi(unsigned v) { return __builtin_bit_cast(float, v & 0xffff0000u); }
__device__ __forceinline__ float sigm(float z) { return __builtin_amdgcn_rcpf(1.f + __expf(-z)); }
__device__ __forceinline__ float siluf(float z) { return z * sigm(z); }
__device__ __forceinline__ float wave_sum(float v) {
#pragma unroll
    for (int o = 1; o < 64; o <<= 1) v += __shfl_xor(v, o);
    return v;
}
__device__ __forceinline__ u32x4 pack8(const f32x4 a, const f32x4 b) { u32x4 w; w.x = cvt_pk_bf16(a[0], a[1]); w.y = cvt_pk_bf16(a[2], a[3]); w.z = cvt_pk_bf16(b[0], b[1]); w.w = cvt_pk_bf16(b[2], b[3]); return w; }
__device__ __forceinline__ void unpack8(const u32x4 w, f32x4& a, f32x4& b) { a = (f32x4){bf_lo(w.x), bf_hi(w.x), bf_lo(w.y), bf_hi(w.y)}; b = (f32x4){bf_lo(w.z), bf_hi(w.z), bf_lo(w.w), bf_hi(w.w)}; }

constexpr int BM = 256, BK = 64, HALF = 128, HTB = HALF * BK * 2, NXCD = 8, WGM = 8;
__device__ __forceinline__ int lds_byte(int r, int c) { const int st = (r >> 4) * 2 + (c >> 5), rr = r & 15, cc = c & 31, ob = rr * 64 + cc * 2; return st * 1024 + (ob ^ (((ob >> 9) & 1) << 5)); }
__device__ __forceinline__ void stage_rc(int b, int& R, int& C) { const int st = b / 1024, sb = b % 1024, swz = sb ^ (((sb >> 9) & 1) << 5); R = (st >> 1) * 16 + swz / 64; C = (st & 1) * 32 + (swz % 64) / 2; }
__device__ __forceinline__ int perm32(int rho) { const int n = rho >> 4, i = rho & 15; return 8 * (i >> 2) + 4 * n + (i & 3); }

struct Unit { int pm, pn, part; };

__device__ __forceinline__ bool tile_order(int L, int nM, int nN, int& pm, int& pn) {
    const int nwg = nM * nN; if (L >= nwg) return false;
    int wgid = L; { const int q = nwg / NXCD, r = nwg % NXCD, xcd = wgid % NXCD, off = wgid / NXCD; wgid = (xcd < r ? xcd * (q + 1) : r * (q + 1) + (xcd - r) * q) + off; }
    const int nig = WGM * nN, gid = wgid / nig, fm = gid * WGM, gsz = (nM - fm) < WGM ? (nM - fm) : WGM;
    pm = fm + ((wgid % nig) % gsz); pn = (wgid % nig) / gsz; return true;
}
struct SchedStd {
    const char* A; const char* B; int lda, ldb, nt, nM, nN, G, c;
    __device__ __forceinline__ bool next(int i, Unit& u) const { u.part = 0; return tile_order(i * G + c, nM, nN, u.pm, u.pn); }
    __device__ __forceinline__ const char* aptr(const Unit& u) const { return A + (size_t)u.pm * BM * lda * 2; }
    __device__ __forceinline__ const char* bptr(const Unit& u) const { return B + (size_t)u.pn * BM * ldb * 2; }
};
struct SchedPair {
    const char *A0, *B0; long dA, dB; int lda, ldb, nt, nM, nN, G, c;
    __device__ __forceinline__ bool next(int i, Unit& u) const { u.part = i & 1; return tile_order((i >> 1) * G + c, nM, nN, u.pm, u.pn); }
    __device__ __forceinline__ const char* aptr(const Unit& u) const { return A0 + (u.part ? dA : 0l) + (size_t)u.pm * BM * lda * 2; }
    __device__ __forceinline__ const char* bptr(const Unit& u) const { return B0 + (u.part ? dB : 0l) + (size_t)u.pn * BM * ldb * 2; }
};
struct SchedOne {
    const char* A; const char* B; int lda, ldb, nt; Unit u0;
    __device__ __forceinline__ bool next(int i, Unit& u) const { if (i > 0) return false; u = u0; return true; }
    __device__ __forceinline__ const char* aptr(const Unit&) const { return A; }
    __device__ __forceinline__ const char* bptr(const Unit&) const { return B; }
};

template <class Epi, class Sched>
__device__ __forceinline__ void gemm_phase(LAS unsigned char* lds, const Sched& S, const Epi& E) {
    const int tid = threadIdx.x, wid = __builtin_amdgcn_readfirstlane(tid >> 6), lane = tid & 63, wr = wid >> 2, wc = wid & 3, fr = lane & 15, fq = lane >> 4;
    const int nt = S.nt;
    unsigned voffA[2], voffB[2];
#pragma unroll
    for (int i = 0; i < 2; ++i) { int R, C; stage_rc(tid * 16 + i * 8192, R, C); const int Rb = (R & ~31) + perm32(R & 31);
        voffA[i] = (unsigned)(R * S.lda + C) * 2u; voffB[i] = (unsigned)(Rb * S.ldb + C) * 2u; }
    const size_t kstep = (size_t)(BK * 2);
    const size_t hstepA = (size_t)HALF * S.lda * 2, hstepB = (size_t)HALF * S.ldb * 2;
    const unsigned ldsw = (unsigned)wid * 1024u;
    const int aoff = lds_byte(wr * 64 + fr, fq * 8), boff = lds_byte(wc * 32 + fr, fq * 8);
#define G_SA(b, h) (((b) * 2 + (h)) * HTB)
#define G_SB(b, h) ((4 + (b) * 2 + (h)) * HTB)
#define G_STAGE(bufoff, gbase, voff) do { _Pragma("unroll") for (int _i = 0; _i < 2; ++_i) \
        __builtin_amdgcn_global_load_lds((const unsigned*)((const char*)(gbase) + (voff)[_i]), (LAS unsigned*)(lds + (bufoff) + ldsw + _i * 8192), 16, 0, 0); } while (0)
#define G_LDA(dst, b, h) do { _Pragma("unroll") for (int m = 0; m < 4; ++m) _Pragma("unroll") for (int k = 0; k < 2; ++k) dst[m][k] = *(const LAS bf16x8*)(lds + G_SA(b, h) + aoff + m * 2048 + k * 1024); } while (0)
#define G_LDB(dst, b, h) do { _Pragma("unroll") for (int n = 0; n < 2; ++n) _Pragma("unroll") for (int k = 0; k < 2; ++k) dst[n][k] = *(const LAS bf16x8*)(lds + G_SB(b, h) + boff + n * 2048 + k * 1024); } while (0)
#define G_MMA(ai, bj, At, Bt) do { __builtin_amdgcn_s_setprio(1); _Pragma("unroll") for (int m = 0; m < 4; ++m) _Pragma("unroll") for (int n = 0; n < 2; ++n) _Pragma("unroll") for (int k = 0; k < 2; ++k) \
        acc[ai][bj][m][n] = __builtin_amdgcn_mfma_f32_16x16x32_bf16(Bt[n][k], At[m][k], acc[ai][bj][m][n], 0, 0, 0); __builtin_amdgcn_s_setprio(0); } while (0)
#define G_WAIT_V(n) asm volatile("s_waitcnt vmcnt(" #n ")" ::: "memory")
#define G_WAIT_L(n) asm volatile("s_waitcnt lgkmcnt(" #n ")" ::: "memory")
#define G_BAR __builtin_amdgcn_s_barrier()
#define G_SCHED __builtin_amdgcn_sched_barrier(0)
    Unit cur, nxt; int ui = 0;
    if (!S.next(0, cur)) return;
    f32x4 acc[2][2][4][2];
#pragma unroll
    for (int a = 0; a < 2; ++a)
#pragma unroll
        for (int b = 0; b < 2; ++b)
#pragma unroll
            for (int m = 0; m < 4; ++m)
#pragma unroll
                for (int n = 0; n < 2; ++n) acc[a][b][m][n] = (f32x4){0.f, 0.f, 0.f, 0.f};
    bf16x8 At[4][2], B0[2][2], B1[2][2];
    const char* cA = S.aptr(cur); const char* cB = S.bptr(cur);
    G_STAGE(G_SB(0, 0), cB, voffB); G_STAGE(G_SB(0, 1), cB + hstepB, voffB); G_STAGE(G_SA(0, 0), cA, voffA); G_STAGE(G_SA(0, 1), cA + hstepA, voffA);
    if (wr == 1) G_BAR;
    G_WAIT_V(2); G_BAR;
    G_STAGE(G_SB(1, 0), cB + kstep, voffB); G_STAGE(G_SA(1, 0), cA + kstep, voffA); G_STAGE(G_SB(1, 1), cB + hstepB + kstep, voffB);
    G_WAIT_V(6); G_BAR;
    for (;;) {
        const bool has_next = S.next(ui + 1, nxt);
        const char* nA = has_next ? S.aptr(nxt) : cA; const char* nB = has_next ? S.bptr(nxt) : cB;
        for (int t = 0; t < nt; t += 2) {
            const bool last = (t == nt - 2);
            const char* a1 = cA + (size_t)(t + 1) * kstep;
            const char* a2 = last ? nA : cA + (size_t)(t + 2) * kstep; const char* b2 = last ? nB : cB + (size_t)(t + 2) * kstep;
            const char* a3 = a2 + kstep; const char* b3 = b2 + kstep;
            G_LDB(B0, 0, 0); G_LDB(B1, 0, 1); G_SCHED; G_LDA(At, 0, 0); G_STAGE(G_SA(1, 1), a1 + hstepA, voffA);
            G_WAIT_V(8); G_WAIT_L(0); G_BAR; G_MMA(0, 0, At, B0); G_MMA(0, 1, At, B1); G_BAR; G_SCHED;
            G_LDA(At, 0, 1); G_STAGE(G_SB(0, 0), b2, voffB); G_STAGE(G_SB(0, 1), b2 + hstepB, voffB); G_STAGE(G_SA(0, 0), a2, voffA);
            G_WAIT_V(8); G_WAIT_L(0); G_BAR; G_MMA(1, 0, At, B0); G_MMA(1, 1, At, B1); G_BAR; G_SCHED;
            G_LDB(B0, 1, 0); G_LDB(B1, 1, 1); G_SCHED; G_LDA(At, 1, 0); G_STAGE(G_SA(0, 1), a2 + hstepA, voffA);
            G_WAIT_V(8); G_WAIT_L(0); G_BAR; G_MMA(0, 0, At, B0); G_MMA(0, 1, At, B1); G_BAR; G_SCHED;
            G_LDA(At, 1, 1); G_STAGE(G_SB(1, 0), b3, voffB); G_STAGE(G_SB(1, 1), b3 + hstepB, voffB); G_STAGE(G_SA(1, 0), a3, voffA);
            G_WAIT_V(8); G_WAIT_L(0); G_BAR; G_MMA(1, 0, At, B0); G_MMA(1, 1, At, B1); G_BAR; G_SCHED;
        }
        if (wr == 0) G_BAR;
        const bool keep = E(acc, cur, wr, wc, fr, fq);
        if (!has_next) break;
        if (!keep) {
#pragma unroll
            for (int a = 0; a < 2; ++a)
#pragma unroll
                for (int b = 0; b < 2; ++b)
#pragma unroll
                    for (int m = 0; m < 4; ++m)
#pragma unroll
                        for (int n = 0; n < 2; ++n) acc[a][b][m][n] = (f32x4){0.f, 0.f, 0.f, 0.f};
        }
        cur = nxt; cA = nA; cB = nB; ++ui;
        if (wr == 1) G_BAR;
    }
    G_WAIT_V(0);
    G_BAR;
#undef G_SA
#undef G_SB
#undef G_STAGE
#undef G_LDA
#undef G_LDB
#undef G_MMA
#undef G_WAIT_V
#undef G_WAIT_L
#undef G_BAR
#undef G_SCHED
}

struct Ctx {
    LAS unsigned char* lds;
    int tid, lane, wave, G, c;
    const float *x_p, *x_s, *st_pool, *st_conv, *p_p, *p_s, *g_pre, *w_in, *w_pool, *pool_scale, *w_dw, *b_dw, *ln_g, *ln_b, *w_pp, *w_pc, *w_out, *g_post, *w_ple, *g_ple, *w_g;
    float* out;
    bf16_t *XB, *WIN, *POOLED, *YA, *U, *SZA, *T, *V, *SZB, *EB, *GA, *GB, *YB, *PB, *WPLE, *WPOOL, *WPP, *WPC, *WOUT, *WG;
    float *RPRE, *ESQ, *TSQ;
};
__device__ __forceinline__ const float* xrow(const Ctx& F, int row) { return row < MP ? F.x_p + (size_t)row * DM : F.x_s + (size_t)(row - MP) * DM; }

struct EpiP1 {
    const float* rpre; bf16_t *U, *SZA, *V, *SZB, *GA, *GB; float* out;
    __device__ __forceinline__ bool operator()(f32x4 (&acc)[2][2][4][2], const Unit& u, int wr, int wc, int fr, int fq) const {
        const int pn = u.pn, rbase = u.pm * BM + wr * 64 + fr, cw = wc * 32 + 8 * fq;
        if (pn >= 8 && pn < 16) {
            const int ch = (pn - 8) * 128 + cw;
#pragma unroll
            for (int ai = 0; ai < 2; ++ai)
#pragma unroll
                for (int m = 0; m < 4; ++m) {
                    const int row = rbase + ai * HALF + m * 16; const float r = rpre[row];
                    f32x4 v0, v1;
#pragma unroll
                    for (int j = 0; j < 4; ++j) { v0[j] = (acc[ai][0][m][0][j] * r) * sigm(acc[ai][1][m][0][j] * r); v1[j] = (acc[ai][0][m][1][j] * r) * sigm(acc[ai][1][m][1][j] * r); }
                    *(u32x4*)(V + (size_t)row * DC + ch) = pack8(v0, v1);
                    float* so = nullptr;
                    if (row >= MP) { const int s = row - MP; so = out + O_CS + ((size_t)((s >> 3) * 30 + 22 + (s & 7))) * DC + ch; }
                    else { const int t = row & (SEQ - 1); if (t >= SEQ - 30) so = out + O_CP + ((size_t)((row >> 11) * 30 + t - (SEQ - 30))) * DC + ch; }
                    if (so) { *(f32x4*)so = v0; *(f32x4*)(so + 4) = v1; }
                }
            return false;
        }
        bf16_t* dst; int ldc, mode;
        if (pn < 4) { dst = U + pn * 256; ldc = DP; mode = 0; }
        else if (pn < 8) { dst = SZA + (pn - 4) * 256; ldc = DP; mode = 1; }
        else if (pn < 20) { dst = SZB + (pn - 16) * 256; ldc = DC; mode = 1; }
        else if (pn < 28) { dst = GA + (pn - 20) * 256; ldc = DM; mode = 2; }
        else { dst = GB + (pn - 28) * 256; ldc = DM; mode = 2; }
#pragma unroll
        for (int ai = 0; ai < 2; ++ai)
#pragma unroll
            for (int m = 0; m < 4; ++m) {
                const int row = rbase + ai * HALF + m * 16; const float r = rpre[row];
#pragma unroll
                for (int bj = 0; bj < 2; ++bj) {
                    f32x4 v0 = acc[ai][bj][m][0] * r, v1 = acc[ai][bj][m][1] * r;
                    if (mode == 1) {
#pragma unroll
                        for (int j = 0; j < 4; ++j) { v0[j] = siluf(v0[j]); v1[j] = siluf(v1[j]); }
                    } else if (mode == 2) {
#pragma unroll
                        for (int j = 0; j < 4; ++j) { v0[j] = sigm(v0[j]); v1[j] = sigm(v1[j]); }
                    }
                    *(u32x4*)(dst + (size_t)row * ldc + bj * HALF + cw) = pack8(v0, v1);
                    if (mode == 0) {
                        const int ch = pn * 256 + bj * HALF + cw; float* so = nullptr;
                        if (row >= MP) { const int s = row - MP; so = out + O_PS + ((size_t)((s >> 3) * 15 + 7 + (s & 7))) * DP + ch; }
                        else { const int t = row & (SEQ - 1); if (t >= SEQ - 15) so = out + O_PP + ((size_t)((row >> 11) * 15 + t - (SEQ - 15))) * DP + ch; }
                        if (so) { *(f32x4*)so = v0; *(f32x4*)(so + 4) = v1; }
                    }
                }
            }
        return false;
    }
};

struct EpiSq {
    bf16_t* O; float* sq;
    __device__ __forceinline__ bool operator()(f32x4 (&acc)[2][2][4][2], const Unit& u, int wr, int wc, int fr, int fq) const {
        const int rbase = u.pm * BM + wr * 64 + fr, col0 = u.pn * BM + wc * 32 + 8 * fq;
#pragma unroll
        for (int ai = 0; ai < 2; ++ai)
#pragma unroll
            for (int m = 0; m < 4; ++m) {
                const int row = rbase + ai * HALF + m * 16; float s = 0.f;
#pragma unroll
                for (int bj = 0; bj < 2; ++bj) {
                    const f32x4 v0 = acc[ai][bj][m][0], v1 = acc[ai][bj][m][1];
                    s += (v0[0] * v0[0] + v0[1] * v0[1]) + (v0[2] * v0[2] + v0[3] * v0[3]) + (v1[0] * v1[0] + v1[1] * v1[1]) + (v1[2] * v1[2] + v1[3] * v1[3]);
                    *(u32x4*)(O + (size_t)row * DM + col0 + bj * HALF) = pack8(v0, v1);
                }
                s += __shfl_xor(s, 16); s += __shfl_xor(s, 32);
                if (fq == 0) atomicAdd(sq + row, s);
            }
        return false;
    }
};

struct EpiPool {
    const float* pool_scale; const bf16_t* SZA; bf16_t* YA;
    __device__ __forceinline__ bool operator()(f32x4 (&acc)[2][2][4][2], const Unit& u, int wr, int wc, int fr, int fq) const {
        const int rbase = u.pm * BM + wr * 64 + fr, col0 = u.pn * BM + wc * 32 + 8 * fq;
#pragma unroll
        for (int bj = 0; bj < 2; ++bj) {
            const f32x4 s0 = *(const f32x4*)(pool_scale + col0 + bj * HALF), s1 = *(const f32x4*)(pool_scale + col0 + bj * HALF + 4);
#pragma unroll
            for (int ai = 0; ai < 2; ++ai)
#pragma unroll
                for (int m = 0; m < 4; ++m) {
                    const size_t off = (size_t)(rbase + ai * HALF + m * 16) * DP + col0 + bj * HALF;
                    f32x4 z0, z1; unpack8(*(const u32x4*)(SZA + off), z0, z1);
                    *(u32x4*)(YA + off) = pack8(acc[ai][bj][m][0] * s0 * z0, acc[ai][bj][m][1] * s1 * z1);
                }
        }
        return false;
    }
};

struct EpiP3 {
    const bf16_t *GA, *GB; bf16_t* MB;
    __device__ __forceinline__ bool operator()(f32x4 (&acc)[2][2][4][2], const Unit& u, int wr, int wc, int fr, int fq) const {
        const int rbase = u.pm * BM + wr * 64 + fr, col0 = u.pn * BM + wc * 32 + 8 * fq;
#pragma unroll
        for (int ai = 0; ai < 2; ++ai)
#pragma unroll
            for (int m = 0; m < 4; ++m)
#pragma unroll
                for (int bj = 0; bj < 2; ++bj) {
                    const size_t off = (size_t)(rbase + ai * HALF + m * 16) * DM + col0 + bj * HALF;
                    f32x4 b0, b1; unpack8(*(const u32x4*)(GB + off), b0, b1);
#pragma unroll
                    for (int j = 0; j < 4; ++j) { b0[j] = fmaxf(b0[j], 1e-30f); b1[j] = fmaxf(b1[j], 1e-30f); }
                    if (u.part == 0) {
                        f32x4 a0, a1; unpack8(*(const u32x4*)(GA + off), a0, a1);
#pragma unroll
                        for (int j = 0; j < 4; ++j) { acc[ai][bj][m][0][j] *= a0[j] * __builtin_amdgcn_rcpf(b0[j]); acc[ai][bj][m][1][j] *= a1[j] * __builtin_amdgcn_rcpf(b1[j]); }
                    } else {
                        *(u32x4*)(MB + off) = pack8(acc[ai][bj][m][0] * b0, acc[ai][bj][m][1] * b1);
                    }
                }
        return u.part == 0;
    }
};

struct EpiP5 {
    const Ctx* F;
    __device__ __forceinline__ bool operator()(f32x4 (&acc)[2][2][4][2], const Unit& u, int wr, int wc, int fr, int fq) const {
        const int rbase = u.pm * BM + wr * 64 + fr, col0 = u.pn * BM + wc * 32 + 8 * fq;
#pragma unroll
        for (int bj = 0; bj < 2; ++bj) {
            const int col = col0 + bj * HALF;
            const f32x4 gp0 = *(const f32x4*)(F->g_post + col), gp1 = *(const f32x4*)(F->g_post + col + 4);
            const f32x4 ge0 = *(const f32x4*)(F->g_ple + col), ge1 = *(const f32x4*)(F->g_ple + col + 4);
#pragma unroll
            for (int ai = 0; ai < 2; ++ai)
#pragma unroll
                for (int m = 0; m < 4; ++m) {
                    const int row = rbase + ai * HALF + m * 16;
                    const float rt = rsqrtf(F->TSQ[row] * (1.f / DM) + EPS), re = rsqrtf(F->ESQ[row] * (1.f / DM) + EPS);
                    const float* xr = xrow(*F, row) + col;
                    const f32x4 x0 = *(const f32x4*)xr, x1 = *(const f32x4*)(xr + 4);
                    f32x4 t0, t1, e0, e1; unpack8(*(const u32x4*)(F->T + (size_t)row * DM + col), t0, t1); unpack8(*(const u32x4*)(F->EB + (size_t)row * DM + col), e0, e1);
                    f32x4 y0, y1;
#pragma unroll
                    for (int j = 0; j < 4; ++j) {
                        y0[j] = x0[j] + t0[j] * rt * gp0[j] + e0[j] * re * ge0[j] * sigm(acc[ai][bj][m][0][j]);
                        y1[j] = x1[j] + t1[j] * rt * gp1[j] + e1[j] * re * ge1[j] * sigm(acc[ai][bj][m][1][j]);
                    }
                    float* o = F->out + O_Y + (size_t)row * DM + col;
                    *(f32x4*)o = y0; *(f32x4*)(o + 4) = y1;
                }
        }
        return false;
    }
};

__device__ __forceinline__ void p0_transpose_item(const float* W, int ldw, int k0, int n0, bf16_t* WT, int ldt, int dst_row0, const float* ks, LAS float* scr, int lane) {
#pragma unroll 8
    for (int i = 0; i < 32; ++i) { const int kk = 2 * i + (lane >> 5); float v = W[(size_t)(k0 + kk) * ldw + n0 + (lane & 31)]; if (ks) v *= ks[k0 + kk]; scr[kk * 33 + (lane & 31)] = v; }
    asm volatile("s_waitcnt lgkmcnt(0)" ::: "memory");
    const int c = lane & 7;
#pragma unroll
    for (int j = 0; j < 4; ++j) { const int n = (lane >> 3) + 8 * j; const LAS float* s = scr + (8 * c) * 33 + n;
        u32x4 o; o.x = cvt_pk_bf16(s[0 * 33], s[1 * 33]); o.y = cvt_pk_bf16(s[2 * 33], s[3 * 33]); o.z = cvt_pk_bf16(s[4 * 33], s[5 * 33]); o.w = cvt_pk_bf16(s[6 * 33], s[7 * 33]);
        *(u32x4*)(WT + (size_t)(dst_row0 + n) * ldt + k0 + 8 * c) = o; }
    asm volatile("s_waitcnt lgkmcnt(0)" ::: "memory");
}
__device__ __forceinline__ void p0_phase(const Ctx& F) {
    LAS float* scr = (LAS float*)(F.lds + F.wave * 16384);
    const int gw = F.c * 8 + F.wave, NGW = F.G * 8;
    constexpr int I_IN = 32 * 288, I_SQ = 32 * 64, I_PR = 16 * 64, I_PLE = 4 * 64, I_POOL = 4 * 32;
    constexpr int NITEMS = I_IN + 2 * I_SQ + 2 * I_PR + I_PLE + I_POOL;
    for (int it = gw; it < NITEMS; it += NGW) {
        int r = it;
        if (r < I_IN) { const int kb = r / 288, nb = r % 288, nd = nb * 32; int ns = nd;
            if (nd >= 2048 && nd < 4096) { const int q = nd - 2048; ns = 2048 + ((q >> 7) & 1) * 1024 + (q >> 8) * 128 + (q & 127); }
            p0_transpose_item(F.w_in, DIN, kb * 64, ns, F.WIN, DM, nd, F.g_pre, scr, F.lane); continue; } r -= I_IN;
        if (r < I_SQ) { p0_transpose_item(F.w_out, DM, (r / 64) * 64, (r % 64) * 32, F.WOUT, DM, (r % 64) * 32, nullptr, scr, F.lane); continue; } r -= I_SQ;
        if (r < I_SQ) { p0_transpose_item(F.w_g, DM, (r / 64) * 64, (r % 64) * 32, F.WG, DM, (r % 64) * 32, nullptr, scr, F.lane); continue; } r -= I_SQ;
        if (r < I_PR) { p0_transpose_item(F.w_pp, DM, (r / 64) * 64, (r % 64) * 32, F.WPP, DP, (r % 64) * 32, nullptr, scr, F.lane); continue; } r -= I_PR;
        if (r < I_PR) { p0_transpose_item(F.w_pc, DM, (r / 64) * 64, (r % 64) * 32, F.WPC, DC, (r % 64) * 32, nullptr, scr, F.lane); continue; } r -= I_PR;
        if (r < I_PLE) { p0_transpose_item(F.w_ple, DM, (r / 64) * 64, (r % 64) * 32, F.WPLE, DPLE, (r % 64) * 32, nullptr, scr, F.lane); continue; } r -= I_PLE;
        { const int g = r >> 5, q = r & 31; p0_transpose_item(F.w_pool + (size_t)g * 65536, 256, (q >> 3) * 64, (q & 7) * 32, F.WPOOL + (size_t)g * 65536, 256, (q & 7) * 32, nullptr, scr, F.lane); }
    }
    for (int m = gw; m < M; m += NGW) {
        const f32x4* xr = (const f32x4*)xrow(F, m) + F.lane; f32x4 v[8]; float s = 0.f;
#pragma unroll
        for (int j = 0; j < 8; ++j) { v[j] = xr[64 * j]; s += (v[j][0] * v[j][0] + v[j][1] * v[j][1]) + (v[j][2] * v[j][2] + v[j][3] * v[j][3]); }
        s = wave_sum(s);
        if (F.lane == 0) F.RPRE[m] = rsqrtf(s * (1.f / DM) + EPS);
        u32x2* o = (u32x2*)(F.XB + (size_t)m * DM) + F.lane;
#pragma unroll
        for (int j = 0; j < 8; ++j) { u32x2 w; w.x = cvt_pk_bf16(v[j][0], v[j][1]); w.y = cvt_pk_bf16(v[j][2], v[j][3]); o[64 * j] = w; }
    }
    const int gt = F.c * 512 + F.tid, NGT = F.G * 512;
    for (int i = gt; i < M * DPLE / 8; i += NGT) {
        const float* src = (i < MP * DPLE / 8) ? F.p_p + (size_t)i * 8 : F.p_s + (size_t)(i - MP * DPLE / 8) * 8;
        *(u32x4*)(F.PB + (size_t)i * 8) = pack8(*(const f32x4*)src, *(const f32x4*)(src + 4));
    }
    for (int i = gt; i < DBATCH * 7 * 256; i += NGT) { const int b = i / (7 * 256), r = i % (7 * 256);
        *(f32x4*)(F.out + O_PS + (size_t)b * 15 * 1024 + (size_t)r * 4) = *(const f32x4*)(F.st_pool + (size_t)b * 15 * 1024 + 8 * 1024 + (size_t)r * 4); }
    for (int i = gt; i < DBATCH * 22 * 256; i += NGT) { const int b = i / (22 * 256), r = i % (22 * 256);
        *(f32x4*)(F.out + O_CS + (size_t)b * 30 * 1024 + (size_t)r * 4) = *(const f32x4*)(F.st_conv + (size_t)b * 30 * 1024 + 8 * 1024 + (size_t)r * 4); }
    for (int i = gt; i < M; i += NGT) { F.ESQ[i] = 0.f; F.TSQ[i] = 0.f; }
}

template <int R>
__device__ __forceinline__ void conv_item(const Ctx& F, int row0, int t0, int sb  ) {
    LAS unsigned* tile = (LAS unsigned*)F.lds;
    LAS float* red = (LAS float*)(F.lds + RED_OFF);
    constexpr int NR = R + 30;
    for (int ch = F.tid; ch < NR * 128; ch += 512) {
        const int lr = ch >> 7, cc = (ch & 127) * 8; u32x4 w = (u32x4){0u, 0u, 0u, 0u};
        if (sb >= 0) {
            if (lr < 30) { const float* s = F.st_conv + ((size_t)sb * 30 + lr) * DC + cc; w = pack8(*(const f32x4*)s, *(const f32x4*)(s + 4)); }
            else w = *(const u32x4*)(F.V + (size_t)(row0 + lr - 30) * DC + cc);
        } else {
            const int t = t0 - 30 + lr;
            if (t >= 0) w = *(const u32x4*)(F.V + (size_t)(row0 - 30 + lr) * DC + cc);
        }
        *(LAS u32x4*)(tile + lr * 512 + (ch & 127) * 4) = w;
    }
    const int c0 = 2 * F.tid;
    float w0[31], w1[31];
    { const float* wp = F.w_dw + c0;
#pragma unroll
      for (int k = 0; k < 31; ++k) { const f32x2 w = *(const f32x2*)wp; w0[k] = w[0]; w1[k] = w[1]; wp += DC; asm volatile("" : "+v"(wp)); } }
    const f32x2 bd = *(const f32x2*)(F.b_dw + c0);
    __syncthreads();
    float y0[R], y1[R];
#pragma unroll
    for (int r = 0; r < R; ++r) {
        float a0 = bd[0], a1 = bd[1];
#pragma unroll
        for (int k = 0; k < 31; ++k) { const unsigned v = tile[(r + k) * 512 + F.tid]; a0 += w0[k] * bf_lo(v); a1 += w1[k] * bf_hi(v); }
        y0[r] = a0; y1[r] = a1;
    }
#pragma unroll
    for (int r = 0; r < R; ++r) {
        const float s1 = wave_sum(y0[r] + y1[r]), s2 = wave_sum(y0[r] * y0[r] + y1[r] * y1[r]);
        if (F.lane == 0) { red[(F.wave * R + r) * 2] = s1; red[(F.wave * R + r) * 2 + 1] = s2; }
    }
    __syncthreads();
    if (F.tid < 2 * R) { float s = 0.f;
#pragma unroll
        for (int w = 0; w < 8; ++w) s += red[w * R * 2 + F.tid];
        red[1024 + F.tid] = s; }
    __syncthreads();
    const f32x2 lg = *(const f32x2*)(F.ln_g + c0), lb = *(const f32x2*)(F.ln_b + c0);
#pragma unroll
    for (int r = 0; r < R; ++r) {
        const float mean = red[1024 + 2 * r] * (1.f / DC), var = fmaxf(red[1024 + 2 * r + 1] * (1.f / DC) - mean * mean, 0.f), rstd = rsqrtf(var + EPS);
        const unsigned z = *(const unsigned*)(F.SZB + (size_t)(row0 + r) * DC + c0);
        const float o0 = siluf((y0[r] - mean) * rstd * lg[0] + lb[0]) * bf_lo(z), o1 = siluf((y1[r] - mean) * rstd * lg[1] + lb[1]) * bf_hi(z);
        *(unsigned*)(F.YB + (size_t)(row0 + r) * DC + c0) = cvt_pk_bf16(o0, o1);
    }
    __syncthreads();
}

__device__ __forceinline__ void pool_item(const Ctx& F, int pm, int g) {
    const int w = 2 << g, cp = F.tid & 127, rs = F.tid >> 7, c = 256 * g + 2 * cp;
    for (int i = 0; i < 64; ++i) {
        const int row = pm * BM + rs * 64 + i;
        const unsigned cur = *(const unsigned*)(F.U + (size_t)row * DP + c);
        float s0 = bf_lo(cur), s1 = bf_hi(cur), cnt;
        if (pm < 32) {
            const int t = row & (SEQ - 1), n = (t + 1 < w) ? t + 1 : w; cnt = (float)n;
            for (int j = 1; j < n; ++j) { const unsigned v = *(const unsigned*)(F.U + (size_t)(row - j) * DP + c); s0 += bf_lo(v); s1 += bf_hi(v); }
        } else {
            const int sr = row - MP, b = sr >> 3, t = sr & 7; cnt = (float)w;
            for (int j = 1; j < w; ++j) { const int tj = t - j;
                if (tj >= 0) { const unsigned v = *(const unsigned*)(F.U + (size_t)(row - j) * DP + c); s0 += bf_lo(v); s1 += bf_hi(v); }
                else { const f32x2 v = *(const f32x2*)(F.st_pool + ((size_t)b * 15 + 15 + tj) * DP + c); s0 += v[0]; s1 += v[1]; } }
        }
        *(unsigned*)(F.POOLED + (size_t)row * DP + c) = cvt_pk_bf16(s0 / cnt - bf_lo(cur), s1 / cnt - bf_hi(cur));
    }
    __threadfence();
    __syncthreads();
    SchedOne S; S.A = (const char*)(F.POOLED + (size_t)pm * BM * DP + 256 * g); S.B = (const char*)(F.WPOOL + (size_t)g * 65536); S.lda = DP; S.ldb = 256; S.nt = 4; S.u0.pm = pm; S.u0.pn = g; S.u0.part = 0;
    EpiPool E{F.pool_scale, F.SZA, F.YA};
    gemm_phase<EpiPool, SchedOne>(F.lds, S, E);
}

__device__ __forceinline__ void p2_phase(const Ctx& F) {
    for (int it = F.c; it < 640; it += F.G) {
        if (it < 512) conv_item<16>(F, it * 16, (it & 127) * 16, -1);
        else conv_item<8>(F, MP + (it - 512) * 8, 0, it - 512);
    }
    for (int it = F.G - 1 - F.c; it < 144; it += F.G) pool_item(F, it >> 2, it & 3);
}

__device__ __forceinline__ void x1_phase(const Ctx& F, bf16_t* X1B) {
    const int gw = F.c * 8 + F.wave, NGW = F.G * 8;
    for (int m = gw; m < M; m += NGW) {
        const float rt = rsqrtf(F.TSQ[m] * (1.f / DM) + EPS);
        const float* xr = xrow(F, m);
#pragma unroll
        for (int j = 0; j < 4; ++j) {
            const int col = j * 512 + F.lane * 8;
            f32x4 t0, t1; unpack8(*(const u32x4*)(F.T + (size_t)m * DM + col), t0, t1);
            const f32x4 x0 = *(const f32x4*)(xr + col), x1 = *(const f32x4*)(xr + col + 4);
            const f32x4 g0 = *(const f32x4*)(F.g_post + col), g1 = *(const f32x4*)(F.g_post + col + 4);
            *(u32x4*)(X1B + (size_t)m * DM + col) = pack8(x0 + t0 * rt * g0, x1 + t1 * rt * g1);
        }
    }
}

struct Args { const float* in[21]; float* out; unsigned char* ws; int ph_lo, ph_hi; };

__global__ void __launch_bounds__(512, 2) hybrid_fwd(Args a) {
    extern __shared__ __attribute__((aligned(16))) unsigned char lds_raw[];
    Ctx F;
    F.lds = (LAS unsigned char*)lds_raw;
    F.tid = threadIdx.x; F.lane = F.tid & 63; F.wave = __builtin_amdgcn_readfirstlane(F.tid >> 6); F.G = gridDim.x; F.c = blockIdx.x;
    F.x_p = a.in[0]; F.x_s = a.in[1]; F.st_pool = a.in[2]; F.st_conv = a.in[3]; F.p_p = a.in[4]; F.p_s = a.in[5]; F.g_pre = a.in[6]; F.w_in = a.in[7]; F.w_pool = a.in[8];
    F.pool_scale = a.in[9]; F.w_dw = a.in[10]; F.b_dw = a.in[11]; F.ln_g = a.in[12]; F.ln_b = a.in[13]; F.w_pp = a.in[14]; F.w_pc = a.in[15]; F.w_out = a.in[16]; F.g_post = a.in[17];
    F.w_ple = a.in[18]; F.g_ple = a.in[19]; F.w_g = a.in[20]; F.out = a.out;
    unsigned char* ws = a.ws;
    F.XB = (bf16_t*)(ws + WS_XB); F.WIN = (bf16_t*)(ws + WS_WIN); F.POOLED = (bf16_t*)(ws + WS_POOLED); F.YA = (bf16_t*)(ws + WS_YA); F.U = (bf16_t*)(ws + WS_U); F.SZA = (bf16_t*)(ws + WS_SZA);
    F.T = (bf16_t*)(ws + WS_T); F.V = (bf16_t*)(ws + WS_V); F.SZB = (bf16_t*)(ws + WS_SZB); F.EB = (bf16_t*)(ws + WS_EB); F.GA = (bf16_t*)(ws + WS_GA); F.GB = (bf16_t*)(ws + WS_GB); F.YB = (bf16_t*)(ws + WS_YB);
    F.PB = (bf16_t*)(ws + WS_PB); F.WPLE = (bf16_t*)(ws + WS_WPLE); F.WPOOL = (bf16_t*)(ws + WS_WPOOL); F.WPP = (bf16_t*)(ws + WS_WPP); F.WPC = (bf16_t*)(ws + WS_WPC);
    F.WOUT = (bf16_t*)(ws + WS_WOUT); F.WG = (bf16_t*)(ws + WS_WG);
    F.RPRE = (float*)(ws + WS_STAT); F.ESQ = F.RPRE + 16384; F.TSQ = F.ESQ + 16384;
    const int lo = a.ph_lo, hi = a.ph_hi;
#define IN(k) (lo <= (k) && (k) < hi)
#define SEAM(k) do { if (IN(k) && IN((k) + 1)) { cg::this_grid().sync(); } } while (0)

    if (IN(0)) { p0_phase(F); }
    SEAM(0);
    if (IN(1)) {
        SchedStd S; S.A = (const char*)F.XB; S.B = (const char*)F.WIN; S.lda = DM; S.ldb = DM; S.nt = DM / BK; S.nM = M / BM; S.nN = DIN / BM; S.G = F.G; S.c = F.c;
        EpiP1 E{F.RPRE, F.U, F.SZA, F.V, F.SZB, F.GA, F.GB, F.out};
        gemm_phase<EpiP1, SchedStd>(F.lds, S, E);
    }
    SEAM(1);
    if (IN(2)) { p2_phase(F); }
    SEAM(2);
    if (IN(3)) {
        SchedPair S; S.A0 = (const char*)F.YA; S.dA = (const char*)F.YB - (const char*)F.YA; S.B0 = (const char*)F.WPP; S.dB = (const char*)F.WPC - (const char*)F.WPP; S.lda = DP; S.ldb = DP; S.nt = DP / BK; S.nM = M / BM; S.nN = DM / BM; S.G = F.G; S.c = F.c;
        EpiP3 E{F.GA, F.GB, F.XB};
        gemm_phase<EpiP3, SchedPair>(F.lds, S, E);
    }
    SEAM(3);
    if (IN(4)) {
        { SchedStd S; S.A = (const char*)F.XB; S.B = (const char*)F.WOUT; S.lda = DM; S.ldb = DM; S.nt = DM / BK; S.nM = M / BM; S.nN = DM / BM; S.G = F.G; S.c = F.c;
          EpiSq E{F.T, F.TSQ}; gemm_phase<EpiSq, SchedStd>(F.lds, S, E); }
        { SchedStd S; S.A = (const char*)F.PB; S.B = (const char*)F.WPLE; S.lda = DPLE; S.ldb = DPLE; S.nt = DPLE / BK; S.nM = M / BM; S.nN = DM / BM; S.G = F.G;
          S.c = (F.c + F.G - (288 % F.G)) % F.G;
          EpiSq E{F.EB, F.ESQ}; gemm_phase<EpiSq, SchedStd>(F.lds, S, E); }
    }
    SEAM(4);
    if (IN(5)) { x1_phase(F, F.XB); }
    SEAM(5);
    if (IN(6)) {
        SchedStd S; S.A = (const char*)F.XB; S.B = (const char*)F.WG; S.lda = DM; S.ldb = DM; S.nt = DM / BK; S.nM = M / BM; S.nN = DM / BM; S.G = F.G; S.c = F.c;
        EpiP5 E{&F};
        gemm_phase<EpiP5, SchedStd>(F.lds, S, E);
    }
}

extern "C" void kernel_launch(void* const* d_in, const int* in_sizes, int n_in, void* d_out, int out_size, void* d_ws, size_t ws_size, hipStream_t stream) {
    static int grid = 0;
    if (grid == 0) {
        int dev = 0, cus = 0, per_cu = 0;
        if (n_in != 21 || ws_size < WS_END) { fprintf(stderr, "kernel_launch: unexpected n_in %d / ws %zu\n", n_in, ws_size); grid = -1; return; }
        hipGetDevice(&dev);
        hipDeviceGetAttribute(&cus, hipDeviceAttributeMultiprocessorCount, dev);
        if (hipFuncSetAttribute((const void*)hybrid_fwd, hipFuncAttributeMaxDynamicSharedMemorySize, LDS_BYTES) != hipSuccess) { fprintf(stderr, "kernel_launch: hipFuncSetAttribute failed\n"); grid = -1; return; }
        if (hipOccupancyMaxActiveBlocksPerMultiprocessor(&per_cu, (const void*)hybrid_fwd, 512, LDS_BYTES) != hipSuccess || per_cu < 1) { fprintf(stderr, "kernel_launch: occupancy query says %d\n", per_cu); per_cu = 1; }
        (void)hipGetLastError();
        grid = cus;
    }
    if (grid < 0) return;
    Args a{};
    for (int i = 0; i < 21; ++i) a.in[i] = (const float*)d_in[i];
    a.out = (float*)d_out; a.ws = (unsigned char*)d_ws;
#if MK_MULTI
    for (int p = 0; p < NPHASE; ++p) {
        a.ph_lo = p; a.ph_hi = p + 1;
        hipLaunchKernelGGL(hybrid_fwd, dim3(grid), dim3(512), LDS_BYTES, stream, a);
    }
#else
    a.ph_lo = 0; a.ph_hi = NPHASE;
    void* args[] = {&a};
    hipError_t e = hipLaunchCooperativeKernel((const void*)hybrid_fwd, dim3(grid), dim3(512), args, LDS_BYTES, stream);
    if (e != hipSuccess) fprintf(stderr, "cooperative launch failed: %s (grid %d)\n", hipGetErrorString(e), grid);
#endif
}
```
